# Optimizing an MI355X kernel written in HIP

```python
import jax
import jax.numpy as jnp
from jax import lax
import numpy as np

D_MODEL = 1024
BATCH = 16
SEQ = 256
DEPTH = 4
DEC_BATCH = 8
DEC_SEQ = 2048
PAST_LEN = 512

GRID_W = 64
N_MIXERS = 3
N_CONV_LAYERS = (DEPTH + 2) // N_MIXERS
N_POOL_LAYERS = (DEPTH + 1) // N_MIXERS
N_ATTN_LAYERS = DEPTH // N_MIXERS
N_SUBLAYERS = 3
N_MOD = 3 * N_SUBLAYERS
D_FF = 2816
N_HEADS = 16
N_KV_HEADS = 4
HEAD_DIM = D_MODEL // N_HEADS
GQA_GROUP = N_HEADS // N_KV_HEADS
QKV_DIM = (N_HEADS + 2 * N_KV_HEADS) * HEAD_DIM
WINDOW = 128
BLOCK = 128
SPAN = BLOCK + 2 * WINDOW
ROPE_THETA = 10000.0
CONV_WIDTH = 3
POOL_WINDOWS = (2, 4, 8, 16)
N_POOL_GROUPS = len(POOL_WINDOWS)
POOL_GROUP_DIM = D_MODEL // N_POOL_GROUPS
DEEPNORM_ALPHA = (2.0 * DEPTH) ** 0.25
DEEPNORM_BETA = (8.0 * DEPTH) ** -0.25
LN_EPS = 1e-5
NEG_INF = -1e30
ATTN_SCALE = HEAD_DIM ** -0.5

kernel_name = 'hybrid_flow_prefix_trunk_step'


def layer_norm(x, g, b):
    xf = x.astype(jnp.float32)
    mu = jnp.mean(xf, axis=-1, keepdims=True)
    var = jnp.mean(jnp.square(xf - mu), axis=-1, keepdims=True)
    y = (xf - mu) * lax.rsqrt(var + LN_EPS)
    return (y * g.astype(jnp.float32) + b.astype(jnp.float32)).astype(x.dtype)


def modulation(cvec, w_mod, b_mod):
    m = jax.nn.silu(cvec) @ w_mod + b_mod
    return m.reshape(cvec.shape[0], N_MOD, 1, D_MODEL)


def modulate(x, mod, j):
    return x * (1.0 + mod[:, 3 * j + 1]) + mod[:, 3 * j]


def post_residual(x, out, mod, j, g, b):
    return layer_norm(DEEPNORM_ALPHA * x + mod[:, 3 * j + 2] * out, g, b)


def swiglu(h, w_gate_up, w_down):
    g, u = jnp.split(h @ w_gate_up, 2, axis=-1)
    return (jax.nn.silu(g) * u) @ w_down


def short_conv_mixer(h, w_in, conv_k, w_out):
    L = h.shape[1]
    b_gate, c_gate, v = jnp.split(h @ w_in, 3, axis=-1)
    u = c_gate * v
    pad = CONV_WIDTH // 2
    up = jnp.pad(u, ((0, 0), (pad, pad), (0, 0)))
    conv = up[:, 0:L] * conv_k[0]
    for tap in range(1, CONV_WIDTH):
        conv = conv + up[:, tap:tap + L] * conv_k[tap]
    return (b_gate * conv) @ w_out


def pool_mixer(h, pool_w, pool_scale):
    B, L, D = h.shape
    hf = h.astype(jnp.float32)
    cs = jnp.concatenate([jnp.zeros((B, 1, D), jnp.float32), lax.cumsum(hf, axis=1)], axis=1)
    t = np.arange(L)
    outs = []
    for g, w in enumerate(POOL_WINDOWS):
        lo = np.clip(t - w // 2, 0, L)
        hi = np.clip(t + w // 2, 0, L)
        sl = slice(g * POOL_GROUP_DIM, (g + 1) * POOL_GROUP_DIM)
        csg = cs[:, :, sl]
        cnt = jnp.asarray((hi - lo)[None, :, None], jnp.float32)
        outs.append((csg[:, hi] - csg[:, lo]) / cnt - hf[:, :, sl])
    d = jnp.stack(outs, axis=2).astype(h.dtype)
    y = jnp.einsum('blgc,gcd->blgd', d, pool_w).reshape(B, L, D)
    return y * pool_scale


def axial_rope_tables(n_rows):
    n_freq = HEAD_DIM // 4
    inv_freq = ROPE_THETA ** (-jnp.arange(n_freq, dtype=jnp.float32) / n_freq)
    t = jnp.arange(n_rows * GRID_W)
    row = (t // GRID_W).astype(jnp.float32)
    col = (t % GRID_W).astype(jnp.float32)
    ang = jnp.concatenate([row[:, None] * inv_freq, col[:, None] * inv_freq], axis=-1)
    return jnp.cos(ang), jnp.sin(ang)


def apply_rope(x, cos, sin):
    xf = x.astype(jnp.float32)
    x1, x2 = jnp.split(xf, 2, axis=-1)
    shape = (1, cos.shape[0]) + (1,) * (x.ndim - 3) + (cos.shape[1],)
    cos = cos.reshape(shape)
    sin = sin.reshape(shape)
    return jnp.concatenate([x1 * cos - x2 * sin, x1 * sin + x2 * cos], axis=-1).astype(x.dtype)


def attn_project(h, w_qkv):
    B, L, _ = h.shape
    qkv = h @ w_qkv
    nq = N_HEADS * HEAD_DIM
    nk = N_KV_HEADS * HEAD_DIM
    q = qkv[..., :nq].reshape(B, L, N_KV_HEADS, GQA_GROUP, HEAD_DIM)
    k = qkv[..., nq:nq + nk].reshape(B, L, N_KV_HEADS, HEAD_DIM)
    v = qkv[..., nq + nk:].reshape(B, L, N_KV_HEADS, HEAD_DIM)
    return q, k, v


def sink_softmax(s, sink):
    sk = sink.astype(jnp.float32)[:, :, None, None]
    m = jnp.maximum(jnp.max(s, axis=-1, keepdims=True), sk)
    p = jnp.exp(s - m)
    return p / (jnp.sum(p, axis=-1, keepdims=True) + jnp.exp(sk - m))


def context_attention(q, k, v, sink):
    B, S = q.shape[0], q.shape[1]
    nb = S // BLOCK
    qb = q.reshape(B, nb, BLOCK, N_KV_HEADS, GQA_GROUP, HEAD_DIM).swapaxes(0, 1)

    def one(qblk):
        s = jnp.einsum('bqhgd,bkhd->bhgqk', qblk, k, preferred_element_type=jnp.float32) * ATTN_SCALE
        p = sink_softmax(s, sink).astype(v.dtype)
        return jnp.einsum('bhgqk,bkhd->bqhgd', p, v)

    o = lax.map(one, qb)
    return o.swapaxes(0, 1).reshape(B, S, D_MODEL)


def latent_attention(q, k, v, ck, cv, sink):
    B, L = q.shape[0], q.shape[1]
    nb = L // BLOCK
    kp = jnp.pad(k, ((0, 0), (WINDOW, WINDOW), (0, 0), (0, 0)))
    vp = jnp.pad(v, ((0, 0), (WINDOW, WINDOW), (0, 0), (0, 0)))
    qb = q.reshape(B, nb, BLOCK, N_KV_HEADS, GQA_GROUP, HEAD_DIM).swapaxes(0, 1)
    starts = jnp.arange(nb, dtype=jnp.int32) * BLOCK
    kpos_rel = np.arange(SPAN) - WINDOW
    band = jnp.asarray(np.abs(kpos_rel[None, :] - np.arange(BLOCK)[:, None]) <= WINDOW)
    kpos_rel_j = jnp.asarray(kpos_rel, jnp.int32)

    def one(args):
        qblk, start = args
        kb = lax.dynamic_slice_in_dim(kp, start, SPAN, axis=1)
        vb = lax.dynamic_slice_in_dim(vp, start, SPAN, axis=1)
        kabs = start + kpos_rel_j
        valid = band & ((kabs >= 0) & (kabs < L))[None, :]
        s_band = jnp.einsum('bqhgd,bkhd->bhgqk', qblk, kb, preferred_element_type=jnp.float32) * ATTN_SCALE
        s_band = jnp.where(valid, s_band, NEG_INF)
        s_ctx = jnp.einsum('bqhgd,bkhd->bhgqk', qblk, ck, preferred_element_type=jnp.float32) * ATTN_SCALE
        p = sink_softmax(jnp.concatenate([s_band, s_ctx], axis=-1), sink).astype(v.dtype)
        return (jnp.einsum('bhgqk,bkhd->bqhgd', p[..., :SPAN], vb)
                + jnp.einsum('bhgqk,bkhd->bqhgd', p[..., SPAN:], cv))

    o = lax.map(one, (qb, starts))
    return o.swapaxes(0, 1).reshape(B, L, D_MODEL)


def setup_inputs(seed: int = 0) -> dict:
    key = jax.random.key(seed)
    ks = jax.random.split(key, 20)
    D = D_MODEL

    def nrm(k, shape, s=1.0):
        return jax.random.normal(k, shape, jnp.float32) * s

    return {
        'x_prompt': nrm(ks[0], (BATCH, SEQ, D)),
        'x_sample': nrm(ks[1], (DEC_BATCH, DEC_SEQ, D)),
        'cache_ctx_k': nrm(ks[2], (DEC_BATCH, N_ATTN_LAYERS, PAST_LEN, N_KV_HEADS, HEAD_DIM)),
        'cache_ctx_v': nrm(ks[3], (DEC_BATCH, N_ATTN_LAYERS, PAST_LEN, N_KV_HEADS, HEAD_DIM)),
        'c': nrm(ks[4], (DEC_BATCH, D)),
        'c_ctx': nrm(ks[5], (D,)),
        'w_mod': nrm(ks[6], (DEPTH, D, N_MOD * D), D ** -0.5),
        'b_mod': nrm(ks[7], (DEPTH, N_MOD * D), 0.01),
        'ln_g': 1.0 + nrm(ks[8], (DEPTH, N_SUBLAYERS, D), 0.02),
        'ln_b': nrm(ks[9], (DEPTH, N_SUBLAYERS, D), 0.02),
        'ffn_w_gate_up': nrm(ks[10], (DEPTH, 2, D, 2 * D_FF), D ** -0.5),
        'ffn_w_down': nrm(ks[11], (DEPTH, 2, D_FF, D), D_FF ** -0.5 * DEEPNORM_BETA),
        'conv_w_in': nrm(ks[12], (N_CONV_LAYERS, D, 3 * D), D ** -0.5),
        'conv_k': nrm(ks[13], (N_CONV_LAYERS, CONV_WIDTH, D), CONV_WIDTH ** -0.5),
        'conv_w_out': nrm(ks[14], (N_CONV_LAYERS, D, D), D ** -0.5 * DEEPNORM_BETA),
        'pool_w': nrm(ks[15], (N_POOL_LAYERS, N_POOL_GROUPS, POOL_GROUP_DIM, POOL_GROUP_DIM),
                      POOL_GROUP_DIM ** -0.5 * DEEPNORM_BETA),
        'pool_scale': 1.0 + nrm(ks[16], (N_POOL_LAYERS, D), 0.02),
        'attn_w_qkv': nrm(ks[17], (N_ATTN_LAYERS, D, QKV_DIM), D ** -0.5),
        'attn_w_o': nrm(ks[18], (N_ATTN_LAYERS, D, D), D ** -0.5 * DEEPNORM_BETA),
        'attn_sink': nrm(ks[19], (N_ATTN_LAYERS, N_HEADS), 0.5),
    }


def reference(x_prompt, x_sample, cache_ctx_k, cache_ctx_v, c, c_ctx, w_mod, b_mod, ln_g, ln_b,
              ffn_w_gate_up, ffn_w_down, conv_w_in, conv_k, conv_w_out, pool_w, pool_scale,
              attn_w_qkv, attn_w_o, attn_sink):
    n_rows = x_sample.shape[1] // GRID_W
    cos, sin = axial_rope_tables(n_rows)
    y_p, y_s = x_prompt, x_sample
    ctx_k_list, ctx_v_list = [], []
    for i in range(DEPTH):
        mod_p = modulation(c_ctx[None, :], w_mod[i], b_mod[i])
        mod_s = modulation(c, w_mod[i], b_mod[i])

        w_gu, w_dn = ffn_w_gate_up[i, 0], ffn_w_down[i, 0]
        y_p = post_residual(y_p, 0.5 * swiglu(modulate(y_p, mod_p, 0), w_gu, w_dn), mod_p, 0, ln_g[i, 0], ln_b[i, 0])
        y_s = post_residual(y_s, 0.5 * swiglu(modulate(y_s, mod_s, 0), w_gu, w_dn), mod_s, 0, ln_g[i, 0], ln_b[i, 0])

        kind, j = i % N_MIXERS, i // N_MIXERS
        h_p = modulate(y_p, mod_p, 1)
        h_s = modulate(y_s, mod_s, 1)
        if kind == 0:
            o_p = short_conv_mixer(h_p, conv_w_in[j], conv_k[j], conv_w_out[j])
            o_s = short_conv_mixer(h_s, conv_w_in[j], conv_k[j], conv_w_out[j])
        elif kind == 1:
            o_p = pool_mixer(h_p, pool_w[j], pool_scale[j])
            o_s = pool_mixer(h_s, pool_w[j], pool_scale[j])
        else:
            sink = attn_sink[j].reshape(N_KV_HEADS, GQA_GROUP)
            q_p, k_p, v_p = attn_project(h_p, attn_w_qkv[j])
            ctx_k_list.append(k_p)
            ctx_v_list.append(v_p)
            o_p = context_attention(q_p, k_p, v_p, sink) @ attn_w_o[j]
            q_s, k_s, v_s = attn_project(h_s, attn_w_qkv[j])
            q_s = apply_rope(q_s, cos, sin)
            k_s = apply_rope(k_s, cos, sin)
            o_s = latent_attention(q_s, k_s, v_s, cache_ctx_k[:, j], cache_ctx_v[:, j], sink) @ attn_w_o[j]
        y_p = post_residual(y_p, o_p, mod_p, 1, ln_g[i, 1], ln_b[i, 1])
        y_s = post_residual(y_s, o_s, mod_s, 1, ln_g[i, 1], ln_b[i, 1])

        w_gu, w_dn = ffn_w_gate_up[i, 1], ffn_w_down[i, 1]
        y_p = post_residual(y_p, 0.5 * swiglu(modulate(y_p, mod_p, 2), w_gu, w_dn), mod_p, 2, ln_g[i, 2], ln_b[i, 2])
        y_s = post_residual(y_s, 0.5 * swiglu(modulate(y_s, mod_s, 2), w_gu, w_dn), mod_s, 2, ln_g[i, 2], ln_b[i, 2])

    ctx_k = jnp.stack(ctx_k_list, axis=1)
    ctx_v = jnp.stack(ctx_v_list, axis=1)
    return (y_p, y_s, ctx_k, ctx_v)
```

```cpp
#include <hip/hip_runtime.h>
#include <hip/hip_cooperative_groups.h>
#include <cstdio>
#include <cstdint>
namespace cg = cooperative_groups;
#ifndef MK_SINGLE
#define MK_SINGLE 0
#endif
#ifndef MK_XCDBAR
#define MK_XCDBAR 0
#endif
namespace pg8 {
#define PG8_LAS __attribute__((address_space(3)))
typedef unsigned short bf16_t;
typedef short bf16x8 __attribute__((ext_vector_type(8)));
typedef float f32x4 __attribute__((ext_vector_type(4)));
typedef unsigned u32x4 __attribute__((ext_vector_type(4)));
constexpr int BM = 256, BK = 64, HALF = 128, HTB = HALF * BK * 2  , STAGE_BYTES = 8 * HTB, NXCD = 8, WGM = 8;

__host__ __device__ __forceinline__ int lds_byte(int r, int c) { const int st = (r >> 4) * 2 + (c >> 5), rr = r & 15, cc = c & 31, ob = rr * 64 + cc * 2; return st * 1024 + (ob ^ (((ob >> 9) & 1) << 5)); }
__host__ __device__ __forceinline__ void stage_rc(int b, int& R, int& C) { const int st = b / 1024, sb = b % 1024, swz = sb ^ (((sb >> 9) & 1) << 5); R = (st >> 1) * 16 + swz / 64; C = (st & 1) * 32 + (swz % 64) / 2; }
__host__ __device__ __forceinline__ int perm32(int rho) { const int n = rho >> 4, i = rho & 15; return 8 * (i >> 2) + 4 * n + (i & 3); }

struct Unit { int pm, pn; };
struct Gemm { const bf16_t* A; const bf16_t* Bt; int M, N, K; };

struct StaticOrder {
    int nM, nN, nwg, G, c;
    __host__ __device__ void init(int M, int N, int G_, int c_) { nM = M / BM; nN = N / BM; nwg = nM * nN; G = G_; c = c_; }
    __host__ __device__ bool next(int i, Unit& u) const {
        const long L = (long)i * G + c; if (L >= nwg) return false;
        int wgid = (int)L; { const int q = nwg / NXCD, r = nwg % NXCD, xcd = wgid % NXCD, off = wgid / NXCD; wgid = (xcd < r ? xcd * (q + 1) : r * (q + 1) + (xcd - r) * q) + off; }
        const int nig = WGM * nN, gid = wgid / nig, fm = gid * WGM, gsz = (nM - fm) < WGM ? (nM - fm) : WGM;
        u.pm = fm + ((wgid % nig) % gsz); u.pn = (wgid % nig) / gsz; return true;
    }
    __device__ __forceinline__ void a_ready(const Unit&) const {}
    __device__ __forceinline__ void done(const Unit&) const {}
};

__device__ __forceinline__ unsigned cvt_pk_bf16(float lo, float hi) { unsigned r; asm volatile("v_cvt_pk_bf16_f32 %0, %1, %2" : "=v"(r) : "v"(lo), "v"(hi)); return r; }
typedef float f32x2 __attribute__((ext_vector_type(2)));
template <class Epi, class Sched, bool ALIGN_EPI = false, bool SP2 = false>
__device__ __forceinline__ void gemm_phase(PG8_LAS unsigned char* lds, const Gemm g, const Sched& S, const Epi& E) {
    int tid_o = threadIdx.x; asm volatile("" : "+v"(tid_o));
    const int tid = tid_o, wid = __builtin_amdgcn_readfirstlane(tid >> 6), lane = tid & 63, wr = wid >> 2, wc = wid & 3, fr = lane & 15, fq = lane >> 4;
    const int K = g.K, nt = K / BK;
    unsigned voffA[2], voffB[2];
#pragma unroll
    for (int i = 0; i < 2; ++i) { int R, C; stage_rc(tid * 16 + i * 8192, R, C); const int Rb = Epi::PERM ? ((R & ~31) + perm32(R & 31)) : R;
        voffA[i] = (unsigned)(R * K + C) * 2u; voffB[i] = (unsigned)(Rb * K + C) * 2u; }
    const size_t kstep = (size_t)(BK * 2);
    const size_t hstep = (size_t)HALF * K * 2;
    const size_t tstep = 2 * hstep;
    const unsigned ldsw = (unsigned)wid * 1024u;
    const int aoff = lds_byte(wr * 64 + fr, fq * 8), boff = lds_byte(wc * 32 + fr, fq * 8);
#define PG8_SA(b, h) (((b) * 2 + (h)) * HTB)
#define PG8_SB(b, h) ((4 + (b) * 2 + (h)) * HTB)
#define PG8_STAGE(bufoff, gbase, voff) do { _Pragma("unroll") for (int _i = 0; _i < 2; ++_i) \
        __builtin_amdgcn_global_load_lds((const unsigned*)((const char*)(gbase) + (voff)[_i]), (PG8_LAS unsigned*)(lds + (bufoff) + ldsw + _i * 8192), 16, 0, 0); } while (0)
#define PG8_LDA(dst, b, h) do { _Pragma("unroll") for (int m = 0; m < 4; ++m) _Pragma("unroll") for (int k = 0; k < 2; ++k) dst[m][k] = *(const PG8_LAS bf16x8*)(lds + PG8_SA(b, h) + aoff + m * 2048 + k * 1024); } while (0)
#define PG8_LDB(dst, b, h) do { _Pragma("unroll") for (int n = 0; n < 2; ++n) _Pragma("unroll") for (int k = 0; k < 2; ++k) dst[n][k] = *(const PG8_LAS bf16x8*)(lds + PG8_SB(b, h) + boff + n * 2048 + k * 1024); } while (0)
#define PG8_MMA(ai, bj, At, Bt) do { __builtin_amdgcn_s_setprio(1); _Pragma("unroll") for (int m = 0; m < 4; ++m) _Pragma("unroll") for (int n = 0; n < 2; ++n) _Pragma("unroll") for (int k = 0; k < 2; ++k) \
        acc[ai][bj][m][n] = __builtin_amdgcn_mfma_f32_16x16x32_bf16(Bt[n][k], At[m][k], acc[ai][bj][m][n], 0, 0, 0); __builtin_amdgcn_s_setprio(0); } while (0)
#define PG8_WAIT_V(n) asm volatile("s_waitcnt vmcnt(" #n ")" ::: "memory")
#define PG8_WAIT_L(n) asm volatile("s_waitcnt lgkmcnt(" #n ")" ::: "memory")
#define PG8_BAR __builtin_amdgcn_s_barrier()
#define PG8_SCHED __builtin_amdgcn_sched_barrier(0)
    Unit cur, nxt; int ui = 0;
    if (!S.next(0, cur)) return;
    f32x4 acc[2][2][4][2];
#pragma unroll
    for (int a = 0; a < 2; ++a)
#pragma unroll
        for (int b = 0; b < 2; ++b)
#pragma unroll
            for (int m = 0; m < 4; ++m)
#pragma unroll
                for (int n = 0; n < 2; ++n) acc[a][b][m][n] = (f32x4){0.f, 0.f, 0.f, 0.f};
    bf16x8 At[4][2], B0[2][2], B1[2][2];
    const char* cA = (const char*)g.A + (size_t)cur.pm * tstep; const char* cB = (const char*)g.Bt + (size_t)cur.pn * tstep;
    S.a_ready(cur);
    if constexpr (SP2) {
        PG8_STAGE(PG8_SB(0, 0), cB, voffB); PG8_STAGE(PG8_SB(0, 1), cB + hstep, voffB); PG8_STAGE(PG8_SA(0, 0), cA, voffA); PG8_STAGE(PG8_SA(0, 1), cA + hstep, voffA);
        if (wr == 1) PG8_BAR;
        PG8_WAIT_V(2); PG8_BAR;
        PG8_STAGE(PG8_SB(1, 0), cB + kstep, voffB); PG8_STAGE(PG8_SA(1, 0), cA + kstep, voffA); PG8_STAGE(PG8_SB(1, 1), cB + hstep + kstep, voffB);
        PG8_WAIT_V(6); PG8_BAR;
    } else {
        PG8_STAGE(PG8_SB(0, 0), cB, voffB); PG8_STAGE(PG8_SA(0, 0), cA, voffA); PG8_STAGE(PG8_SB(0, 1), cB + hstep, voffB); PG8_STAGE(PG8_SA(0, 1), cA + hstep, voffA);
        if (wr == 1) PG8_BAR;
        PG8_WAIT_V(4); PG8_BAR;
        PG8_STAGE(PG8_SB(1, 0), cB + kstep, voffB); PG8_STAGE(PG8_SA(1, 0), cA + kstep, voffA); PG8_STAGE(PG8_SB(1, 1), cB + hstep + kstep, voffB);
        PG8_WAIT_V(6); PG8_BAR;
    }
    for (;;) {
        const bool has_next = S.next(ui + 1, nxt);
        const char* nA = has_next ? (const char*)g.A + (size_t)nxt.pm * tstep : cA; const char* nB = has_next ? (const char*)g.Bt + (size_t)nxt.pn * tstep : cB;
        for (int t = 0; t < nt; t += 2) {
            const bool last = (t == nt - 2);
            const char* a1 = cA + (size_t)(t + 1) * kstep;
            const char* a2 = last ? nA : cA + (size_t)(t + 2) * kstep; const char* b2 = last ? nB : cB + (size_t)(t + 2) * kstep;
            const char* a3 = a2 + kstep; const char* b3 = b2 + kstep;
            if (last && has_next) S.a_ready(nxt);
            if constexpr (SP2) {
            PG8_LDB(B0, 0, 0); PG8_LDB(B1, 0, 1); PG8_SCHED; PG8_LDA(At, 0, 0); PG8_STAGE(PG8_SA(1, 1), a1 + hstep, voffA);
            PG8_WAIT_V(8); PG8_WAIT_L(0); PG8_BAR; PG8_MMA(0, 0, At, B0); PG8_MMA(0, 1, At, B1); PG8_BAR; PG8_SCHED;
            PG8_LDA(At, 0, 1); PG8_STAGE(PG8_SB(0, 0), b2, voffB); PG8_STAGE(PG8_SB(0, 1), b2 + hstep, voffB); PG8_STAGE(PG8_SA(0, 0), a2, voffA);
            PG8_WAIT_V(8); PG8_WAIT_L(0); PG8_BAR; PG8_MMA(1, 0, At, B0); PG8_MMA(1, 1, At, B1); PG8_BAR; PG8_SCHED;
            PG8_LDB(B0, 1, 0); PG8_LDB(B1, 1, 1); PG8_SCHED; PG8_LDA(At, 1, 0); PG8_STAGE(PG8_SA(0, 1), a2 + hstep, voffA);
            PG8_WAIT_V(8); PG8_WAIT_L(0); PG8_BAR; PG8_MMA(0, 0, At, B0); PG8_MMA(0, 1, At, B1); PG8_BAR; PG8_SCHED;
            PG8_LDA(At, 1, 1); PG8_STAGE(PG8_SB(1, 0), b3, voffB); PG8_STAGE(PG8_SB(1, 1), b3 + hstep, voffB); PG8_STAGE(PG8_SA(1, 0), a3, voffA);
            PG8_WAIT_V(8); PG8_WAIT_L(0); PG8_BAR; PG8_MMA(1, 0, At, B0); PG8_MMA(1, 1, At, B1); PG8_BAR; PG8_SCHED;
            } else {
            PG8_LDB(B0, 0, 0); PG8_SCHED; PG8_LDA(At, 0, 0); PG8_STAGE(PG8_SA(1, 1), a1 + hstep, voffA);
            PG8_WAIT_L(8); PG8_BAR; PG8_WAIT_L(0); PG8_MMA(0, 0, At, B0); PG8_BAR; PG8_SCHED;
            PG8_LDB(B1, 0, 1); PG8_STAGE(PG8_SB(0, 0), b2, voffB);
            PG8_BAR; PG8_WAIT_L(0); PG8_MMA(0, 1, At, B1); PG8_BAR;
            PG8_LDA(At, 0, 1); PG8_STAGE(PG8_SA(0, 0), a2, voffA);
            PG8_BAR; PG8_WAIT_L(0); PG8_MMA(1, 0, At, B0); PG8_BAR; PG8_SCHED;
            PG8_STAGE(PG8_SB(0, 1), b2 + hstep, voffB);
            PG8_WAIT_V(6); PG8_BAR; PG8_MMA(1, 1, At, B1); PG8_BAR;
            PG8_LDB(B0, 1, 0); PG8_SCHED; PG8_LDA(At, 1, 0); PG8_STAGE(PG8_SA(0, 1), a2 + hstep, voffA);
            PG8_WAIT_L(8); PG8_BAR; PG8_WAIT_L(0); PG8_MMA(0, 0, At, B0); PG8_BAR; PG8_SCHED;
            PG8_LDB(B1, 1, 1); PG8_STAGE(PG8_SB(1, 0), b3, voffB);
            PG8_BAR; PG8_WAIT_L(0); PG8_MMA(0, 1, At, B1); PG8_BAR;
            PG8_LDA(At, 1, 1); PG8_STAGE(PG8_SA(1, 0), a3, voffA);
            PG8_BAR; PG8_WAIT_L(0); PG8_MMA(1, 0, At, B0); PG8_BAR; PG8_SCHED;
            PG8_STAGE(PG8_SB(1, 1), b3 + hstep, voffB);
            PG8_WAIT_V(6); PG8_BAR; PG8_MMA(1, 1, At, B1); PG8_BAR;
            }
        }
        if constexpr (ALIGN_EPI) { if (wr == 0) PG8_BAR; }
        if constexpr (!Epi::AFTER_DRAIN) { E(acc, cur, wr, wc, fr, fq); S.done(cur); }
        if (!has_next) break;
#pragma unroll
        for (int a = 0; a < 2; ++a)
#pragma unroll
            for (int b = 0; b < 2; ++b)
#pragma unroll
                for (int m = 0; m < 4; ++m)
#pragma unroll
                    for (int n = 0; n < 2; ++n) acc[a][b][m][n] = (f32x4){0.f, 0.f, 0.f, 0.f};
        cur = nxt; cA = nA; cB = nB; ++ui;
        if constexpr (ALIGN_EPI) { if (wr == 1) PG8_BAR; }
    }
    PG8_WAIT_V(0);
    if constexpr (!ALIGN_EPI) { if (wr == 0) PG8_BAR; }
    PG8_BAR;
    if constexpr (Epi::AFTER_DRAIN) { E.fused(acc, cur, wr, wc, fr, fq, lds, wid, lane); S.done(cur); }
#undef PG8_SA
#undef PG8_SB
#undef PG8_STAGE
#undef PG8_LDA
#undef PG8_LDB
#undef PG8_MMA
#undef PG8_WAIT_V
#undef PG8_WAIT_L
#undef PG8_BAR
#undef PG8_SCHED
}
}

#define LAS __attribute__((address_space(3)))
using pg8::bf16_t; using pg8::f32x4; using pg8::u32x4; using pg8::Unit;
typedef short bf16x8_t __attribute__((ext_vector_type(8)));
typedef short s16x4_t __attribute__((ext_vector_type(4)));
typedef float f32x16_t __attribute__((ext_vector_type(16)));
typedef unsigned u32x2_t __attribute__((ext_vector_type(2)));
typedef float f32x2_t __attribute__((ext_vector_type(2)));

constexpr int D = 1024, TP = 4096, T = 20480, DFF = 2816, NMODC = 9216, NCI = 9;
constexpr float ALPHA = 1.6817928305074290f;
constexpr float LN_EPS = 1e-5f, LOG2E = 1.4426950408889634f, QSCALE = 0.125f * 1.4426950408889634f;
constexpr int UVLD = 52736;
constexpr size_t MiB = 1u << 20;
constexpr size_t WS_CTL = 0, CTL_BYTES = 4 * MiB, WS_ST = 1 * MiB;
constexpr size_t WS_MOD = 4 * MiB, WS_CS = 6 * MiB, WS_CVEC = 7 * MiB, WS_UV = 8 * MiB, WS_AUXA = 12 * MiB, WS_CK = 18 * MiB, WS_CV = 20 * MiB;
constexpr size_t WS_ONES = 22 * MiB, WS_ZEROS = 22 * MiB + 4096, WS_GTAB = 23 * MiB;
constexpr size_t WS_WSTK = 24 * MiB, WS_WDN = 128 * MiB, WS_WSQ = 172 * MiB, WS_ZT = 180 * MiB, WS_HID = 220 * MiB, WS_END = 348 * MiB;
constexpr size_t HID_U3 = WS_HID, HID_BG = WS_HID + 40 * MiB, HID_A2 = WS_HID + 80 * MiB;
constexpr size_t HID_Q = WS_HID, HID_K = WS_HID + 40 * MiB, HID_V = WS_HID + 50 * MiB, HID_O = WS_HID + 60 * MiB;
constexpr size_t HID_PD = WS_HID;
constexpr int OUT_K = T * D, OUT_V = T * D + 16 * 256 * 256;
constexpr int LDS_BYTES = 147456;

__constant__ int C_SOFF[12] = {0, 5632, 8704, 14336, 0, 19968, 25600, 31232, 32768, 38400, 44032, 47104};
__constant__ int C_CIDX[12] = {0, 1, 2, 3, 0, 4, 5, 6, 7, 8, 9, 10};
__constant__ int C_TOFF[12] = {0, 22, 34, 56, 78, 100, 122, 128, 150, 172, 184, 206};
enum { ST_PROA, ST_PROB, ST_AUX, ST_GU, ST_DN, ST_CIN, ST_CONV, ST_COUT, ST_PPRE, ST_PGEMM, ST_QKV, ST_ATTN, ST_WO, ST_FINAL };
constexpr int NSTEPS = 31;
__constant__ unsigned char C_STEP_T[NSTEPS] = { ST_PROA, ST_PROB, ST_AUX,
    ST_GU, ST_DN, ST_CIN, ST_CONV, ST_COUT, ST_GU, ST_DN,
    ST_GU, ST_DN, ST_PPRE, ST_PGEMM, ST_GU, ST_DN,
    ST_GU, ST_DN, ST_QKV, ST_ATTN, ST_WO, ST_GU, ST_DN,
    ST_GU, ST_DN, ST_CIN, ST_CONV, ST_COUT, ST_GU, ST_DN, ST_FINAL };
__constant__ unsigned char C_STEP_S[NSTEPS] = { 0, 0, 0,
    0, 0, 1, 1, 1, 2, 2,
    3, 3, 4, 4, 5, 5,
    6, 6, 7, 7, 7, 8, 8,
    9, 9, 10, 10, 10, 11, 11, 11 };

struct Args { const float* in[20]; float* out; unsigned char* ws; int lo, hi; };
typedef const __attribute__((address_space(4))) Args* AP;

__device__ __forceinline__ int ci_of_pm(int pm) { return pm < 16 ? 0 : 1 + ((pm - 16) >> 3); }
__device__ __forceinline__ unsigned f2bf(float f) { unsigned u = __builtin_bit_cast(unsigned, f); return (u + 0x7fffu + ((u >> 16) & 1u)) >> 16; }
__device__ __forceinline__ unsigned pk2(float lo, float hi) { return f2bf(lo) | (f2bf(hi) << 16); }
__device__ __forceinline__ float bflo(unsigned w) { return __uint_as_float(w << 16); }
__device__ __forceinline__ float bfhi(unsigned w) { return __uint_as_float(w & 0xffff0000u); }
__device__ __forceinline__ u32x4 pack8(const f32x4& a, const f32x4& b) { u32x4 w; w.x = pg8::cvt_pk_bf16(a[0], a[1]); w.y = pg8::cvt_pk_bf16(a[2], a[3]); w.z = pg8::cvt_pk_bf16(b[0], b[1]); w.w = pg8::cvt_pk_bf16(b[2], b[3]); return w; }
#define LDS_WAIT() asm volatile("s_waitcnt lgkmcnt(0)" ::: "memory")
__device__ __forceinline__ int opq(int x) { asm volatile("" : "+s"(x)); return x; }
#define BID opq((int)blockIdx.x)
#define GRD opq((int)gridDim.x)

__device__ __forceinline__ void row_ac(const float* st, int row, float& a, float& c) {
    const f32x2_t v = *(const f32x2_t*)(st + 2 * (size_t)row); const float mu = v.x * (1.f / D); const float var = v.y * (1.f / D) - mu * mu; const float r = rsqrtf(var + LN_EPS); a = r; c = -mu * r;
}

struct EpiAux {
    static constexpr bool PERM = true, AFTER_DRAIN = false;
    AP a0;
    __device__ __forceinline__ void operator()(const f32x4 (&acc)[2][2][4][2], const Unit& u, int wr, int wc, int fr, int fq) const {
        if (wr != 0) return;
        AP a = a0; asm volatile("" : "+s"(a)); float* UV = (float*)(a->ws + WS_UV);
#pragma unroll
        for (int m = 0; m < 2; ++m) { const int row = 16 * m + fr;
            if (row < 18) {
#pragma unroll
                for (int bj = 0; bj < 2; ++bj)
#pragma unroll
                    for (int n = 0; n < 2; ++n) *(f32x4*)(UV + (size_t)row * UVLD + u.pn * 256 + 128 * bj + 32 * wc + 8 * fq + 4 * n) = acc[0][bj][m][n]; } }
    }
};

struct EpiSwiGLU {
    static constexpr bool PERM = true, AFTER_DRAIN = false;
    AP a0; int s;
    __device__ __forceinline__ void operator()(const f32x4 (&acc)[2][2][4][2], const Unit& u, int wr, int wc, int fr, int fq) const {
        AP a = a0; asm volatile("" : "+s"(a));
        bf16_t* H = (bf16_t*)(a->ws + WS_HID); const float* UVc = (const float*)(a->ws + WS_UV) + C_SOFF[s]; const float* stp = (const float*)(a->ws + WS_ST) + (size_t)s * T * 2;
        const int ci = ci_of_pm(u.pm); const int colp = u.pn * 256 + wc * 32 + 8 * fq;
        const float* Up = UVc + (size_t)(2 * ci) * UVLD + colp; const float* Vp = Up + UVLD;
        f32x4 Uv[2][2], Vv[2][2];
#pragma unroll
        for (int bj = 0; bj < 2; ++bj)
#pragma unroll
            for (int n = 0; n < 2; ++n) { Uv[bj][n] = *(const f32x4*)(Up + 128 * bj + 4 * n); Vv[bj][n] = *(const f32x4*)(Vp + 128 * bj + 4 * n); }
#pragma unroll
        for (int ai = 0; ai < 2; ++ai)
#pragma unroll
            for (int m = 0; m < 4; ++m) { const int row = u.pm * 256 + ai * 128 + wr * 64 + m * 16 + fr; float a, c; row_ac(stp, row, a, c);
                f32x4 h[2];
#pragma unroll
                for (int n = 0; n < 2; ++n) { const f32x4 g = acc[ai][0][m][n] * a + Uv[0][n] * c + Vv[0][n]; const f32x4 uu = acc[ai][1][m][n] * a + Uv[1][n] * c + Vv[1][n];
#pragma unroll
                    for (int e = 0; e < 4; ++e) h[n][e] = g[e] * __builtin_amdgcn_rcpf(1.f + __builtin_amdgcn_exp2f(-g[e] * LOG2E)) * uu[e]; }
                *(u32x4*)(H + (size_t)row * DFF + u.pn * 128 + wc * 32 + 8 * fq) = pack8(h[0], h[1]); }
    }
};

struct EpiResid {
    static constexpr bool PERM = true, AFTER_DRAIN = false;
    AP a0; int s;
    __device__ __forceinline__ void operator()(const f32x4 (&acc)[2][2][4][2], const Unit& u, int wr, int wc, int fr, int fq) const {
        AP a = a0; asm volatile("" : "+s"(a));
        float* Z = a->out; bf16_t* ZT = (bf16_t*)(a->ws + WS_ZT); const float* stp = (const float*)(a->ws + WS_ST) + (size_t)s * T * 2; float* stn = (float*)(a->ws + WS_ST) + (size_t)(s + 1) * T * 2;
        const float* lng = s ? a->in[8] + (s - 1) * D : (const float*)(a->ws + WS_ONES); const float* lnb = s ? a->in[9] + (s - 1) * D : (const float*)(a->ws + WS_ZEROS);
        const float* gt = (const float*)(a->ws + WS_GTAB) + (size_t)s * NCI * D; const float* csn = (const float*)(a->ws + WS_CS) + (size_t)(s + 1) * NCI * D;
        const int ci = ci_of_pm(u.pm); const int colb = u.pn * 256 + wc * 32 + 8 * fq; const int row0 = u.pm * 256 + wr * 64 + fr;
#pragma unroll
        for (int bj = 0; bj < 2; ++bj) { const int col = colb + 128 * bj;
            f32x4 GA[2], BA[2], GT[2], CN[2];
#pragma unroll
            for (int n = 0; n < 2; ++n) {
                GA[n] = *(const f32x4*)(lng + col + 4 * n) * ALPHA; BA[n] = *(const f32x4*)(lnb + col + 4 * n) * ALPHA;
                GT[n] = *(const f32x4*)(gt + ci * D + col + 4 * n); CN[n] = *(const f32x4*)(csn + ci * D + col + 4 * n); }
#pragma unroll
            for (int i = 0; i < 8; ++i) { const int ai = i >> 2, m = i & 3; const int row = row0 + ai * 128 + m * 16;
                float* zr = Z + (size_t)row * D;
                float ra, rc; row_ac(stp, row, ra, rc);
                f32x4 zt[2]; float s1 = 0.f, s2 = 0.f;
#pragma unroll
                for (int n = 0; n < 2; ++n) { const f32x4 zp = *(const f32x4*)(zr + col + 4 * n);
                    const f32x4 zn = (zp * ra + rc) * GA[n] + BA[n] + GT[n] * acc[ai][bj][m][n]; *(f32x4*)(zr + col + 4 * n) = zn;
                    s1 += (zn[0] + zn[1]) + (zn[2] + zn[3]); s2 += (zn[0] * zn[0] + zn[1] * zn[1]) + (zn[2] * zn[2] + zn[3] * zn[3]); zt[n] = zn * CN[n]; }
                *(u32x4*)(ZT + (size_t)row * D + col) = pack8(zt[0], zt[1]);
                s1 += __shfl_xor(s1, 16); s1 += __shfl_xor(s1, 32); s2 += __shfl_xor(s2, 16); s2 += __shfl_xor(s2, 32);
                if (fq == 0) { float* p = stn + 2 * (size_t)row; unsafeAtomicAdd(p, s1); unsafeAtomicAdd(p + 1, s2); }
                asm volatile("" ::: "memory"); } }
    }
};

struct EpiConvIn {
    static constexpr bool PERM = true, AFTER_DRAIN = false;
    AP a0; int s;
    __device__ __forceinline__ void operator()(const f32x4 (&acc)[2][2][4][2], const Unit& u, int wr, int wc, int fr, int fq) const {
        AP a = a0; asm volatile("" : "+s"(a));
        bf16_t* U3 = (bf16_t*)(a->ws + HID_U3); bf16_t* BG = (bf16_t*)(a->ws + HID_BG); const float* UVc = (const float*)(a->ws + WS_UV) + C_SOFF[s]; const float* stp = (const float*)(a->ws + WS_ST) + (size_t)s * T * 2;
        const int ci = ci_of_pm(u.pm); const int colp = u.pn * 256 + wc * 32 + 8 * fq;
        const float* Up = UVc + (size_t)(2 * ci) * UVLD + colp; const float* Vp = Up + UVLD;
        f32x4 Uv[2][2], Vv[2][2];
#pragma unroll
        for (int bj = 0; bj < 2; ++bj)
#pragma unroll
            for (int n = 0; n < 2; ++n) { Uv[bj][n] = *(const f32x4*)(Up + 128 * bj + 4 * n); Vv[bj][n] = *(const f32x4*)(Vp + 128 * bj + 4 * n); }
#pragma unroll
        for (int ai = 0; ai < 2; ++ai)
#pragma unroll
            for (int m = 0; m < 4; ++m) { const int row = u.pm * 256 + ai * 128 + wr * 64 + m * 16 + fr; float a, c; row_ac(stp, row, a, c);
                f32x4 v[2][2];
#pragma unroll
                for (int bj = 0; bj < 2; ++bj)
#pragma unroll
                    for (int n = 0; n < 2; ++n) v[bj][n] = acc[ai][bj][m][n] * a + Uv[bj][n] * c + Vv[bj][n];
                if (u.pn < 8) { *(u32x4*)(U3 + (size_t)row * D + u.pn * 128 + wc * 32 + 8 * fq) = pack8(v[0][0] * v[1][0], v[0][1] * v[1][1]); }
                else {
#pragma unroll
                    for (int bj = 0; bj < 2; ++bj) *(u32x4*)(BG + (size_t)row * D + (u.pn - 8) * 256 + 128 * bj + wc * 32 + 8 * fq) = pack8(v[bj][0], v[bj][1]); } }
    }
};

struct EpiQKV {
    static constexpr bool PERM = true, AFTER_DRAIN = false;
    AP a0; int s;
    __device__ __forceinline__ void operator()(const f32x4 (&acc)[2][2][4][2], const Unit& u, int wr, int wc, int fr, int fq) const {
        AP a = a0; asm volatile("" : "+s"(a));
        bf16_t* Q = (bf16_t*)(a->ws + HID_Q); bf16_t* Kb = (bf16_t*)(a->ws + HID_K); bf16_t* Vb = (bf16_t*)(a->ws + HID_V); float* outk = a->out + OUT_K; float* outv = a->out + OUT_V;
        const float* UVc = (const float*)(a->ws + WS_UV) + C_SOFF[s]; const float* stp = (const float*)(a->ws + WS_ST) + (size_t)s * T * 2;
        const int ci = ci_of_pm(u.pm); const int colp = u.pn * 256 + wc * 32 + 8 * fq; const bool prompt = u.pm < 16;
        const float* Up = UVc + (size_t)(2 * ci) * UVLD + colp; const float* Vp = Up + UVLD;
        f32x4 Uv[2][2], Vv[2][2];
#pragma unroll
        for (int bj = 0; bj < 2; ++bj)
#pragma unroll
            for (int n = 0; n < 2; ++n) { Uv[bj][n] = *(const f32x4*)(Up + 128 * bj + 4 * n); Vv[bj][n] = *(const f32x4*)(Vp + 128 * bj + 4 * n); }
        float invf[2][4];
#pragma unroll
        for (int n = 0; n < 2; ++n)
#pragma unroll
            for (int e = 0; e < 4; ++e) invf[n][e] = __builtin_amdgcn_exp2f(-(float)(8 * (fq & 1) + 4 * n + e) * (13.287712379549449f / 16.f));
#pragma unroll
        for (int ai = 0; ai < 2; ++ai)
#pragma unroll
            for (int m = 0; m < 4; ++m) { const int row = u.pm * 256 + ai * 128 + wr * 64 + m * 16 + fr; float a, c; row_ac(stp, row, a, c);
                f32x4 v[2][2];
#pragma unroll
                for (int bj = 0; bj < 2; ++bj)
#pragma unroll
                    for (int n = 0; n < 2; ++n) v[bj][n] = acc[ai][bj][m][n] * a + Uv[bj][n] * c + Vv[bj][n];
                if (u.pn <= 4) {
                    if (!prompt) { const int t = (row - TP) & 2047; const float pos = (float)((fq < 2) ? (t >> 6) : (t & 63));
#pragma unroll
                        for (int n = 0; n < 2; ++n)
#pragma unroll
                            for (int e = 0; e < 4; ++e) { const float ang = pos * invf[n][e]; const float cs = __cosf(ang), sn = __sinf(ang); const float x1 = v[0][n][e], x2 = v[1][n][e];
                                v[0][n][e] = x1 * cs - x2 * sn; v[1][n][e] = x1 * sn + x2 * cs; } }
                    if (u.pn < 4) {
#pragma unroll
                        for (int bj = 0; bj < 2; ++bj) *(u32x4*)(Q + (size_t)row * D + (4 * u.pn + wc) * 64 + 32 * bj + 8 * fq) = pack8(v[bj][0] * QSCALE, v[bj][1] * QSCALE);
                    } else {
#pragma unroll
                        for (int bj = 0; bj < 2; ++bj) { const int cc = wc * 64 + 32 * bj + 8 * fq; *(u32x4*)(Kb + (size_t)row * 256 + cc) = pack8(v[bj][0], v[bj][1]);
                            if (prompt) { *(f32x4*)(outk + (size_t)row * 256 + cc) = v[bj][0]; *(f32x4*)(outk + (size_t)row * 256 + cc + 4) = v[bj][1]; } }
                    }
                } else {
#pragma unroll
                    for (int bj = 0; bj < 2; ++bj) { const int cc = 128 * bj + 32 * wc + 8 * fq; *(u32x4*)(Vb + (size_t)row * 256 + cc) = pack8(v[bj][0], v[bj][1]);
                        if (prompt) { *(f32x4*)(outv + (size_t)row * 256 + cc) = v[bj][0]; *(f32x4*)(outv + (size_t)row * 256 + cc + 4) = v[bj][1]; } }
                }
                asm volatile("" ::: "memory"); }
    }
};

struct AuxSched {
    int G, c;
    __device__ __forceinline__ bool next(int i, Unit& u) const { const int L = i * G + c; if (L >= 206) return false; u.pn = L; int pm = 0;
#pragma unroll
        for (int q = 1; q < 11; ++q) pm += (L >= C_TOFF[q]) ? 1 : 0;
        u.pm = pm; return true; }
    __device__ __forceinline__ void a_ready(const Unit&) const {}
    __device__ __forceinline__ void done(const Unit&) const {}
};

enum { PM_ID, PM_GU, PM_CIN, PM_QKV };
__device__ __forceinline__ int perm_row(int type, int c) {
    if (type == PM_GU) { const int bj = c >= DFF ? 1 : 0, r = c - bj * DFF; return 256 * (r >> 7) + 128 * bj + (r & 127); }
    if (type == PM_CIN) { if (c < 1024) return 2048 + c; const int q = c - 1024, bj = q >> 10, r = q & 1023; return 256 * (r >> 7) + 128 * bj + (r & 127); }
    if (type == PM_QKV) { if (c >= 1280) return c; const int head = c >> 6, d = c & 63; return 256 * (head >> 2) + 128 * (d >> 5) + 32 * (head & 3) + (d & 31); }
    return c;
}
struct MatDesc { const float* W; bf16_t* WT; int K, N, ldk, type; };
__device__ __forceinline__ MatDesc mat_desc(AP a, int id) {
    MatDesc m; bf16_t* wstk = (bf16_t*)(a->ws + WS_WSTK); bf16_t* wdn = (bf16_t*)(a->ws + WS_WDN); bf16_t* wsq = (bf16_t*)(a->ws + WS_WSQ);
    if (id < 8) { const int s = 3 * (id >> 1) + ((id & 1) ? 2 : 0); m.W = a->in[10] + (size_t)id * D * 5632; m.K = D; m.N = 5632; m.WT = wstk + (size_t)C_SOFF[s] * D; m.ldk = D; m.type = PM_GU; }
    else if (id < 16) { const int f = id - 8; m.W = a->in[11] + (size_t)f * DFF * D; m.K = DFF; m.N = D; m.WT = wdn + (size_t)f * D * DFF; m.ldk = DFF; m.type = PM_ID; }
    else if (id < 18) { const int j = id - 16; m.W = a->in[12] + (size_t)j * D * 3072; m.K = D; m.N = 3072; m.WT = wstk + (size_t)C_SOFF[j ? 10 : 1] * D; m.ldk = D; m.type = PM_CIN; }
    else if (id < 20) { const int j = id - 18; m.W = a->in[14] + (size_t)j * D * D; m.K = D; m.N = D; m.WT = wsq + (size_t)j * D * D; m.ldk = D; m.type = PM_ID; }
    else if (id == 20) { m.W = a->in[17]; m.K = D; m.N = 1536; m.WT = wstk + (size_t)C_SOFF[7] * D; m.ldk = D; m.type = PM_QKV; }
    else if (id == 21) { m.W = a->in[18]; m.K = D; m.N = D; m.WT = wsq + (size_t)3 * D * D; m.ldk = D; m.type = PM_ID; }
    else { const int g = id - 22; m.W = a->in[15] + (size_t)g * 65536; m.K = 256; m.N = 256; m.WT = wsq + (size_t)2 * D * D + (size_t)(256 * g) * D + 256 * g; m.ldk = D; m.type = PM_ID; }
    return m;
}
__device__ __forceinline__ void transpose_item(const MatDesc& m, LAS float* scr, int item, int lane) {
    const int nblk = m.N / 32, kb = item / nblk, nb = item % nblk, k0 = 64 * kb, n0 = 32 * nb;
#pragma unroll 8
    for (int i = 0; i < 32; ++i) { const int kk = 2 * i + (lane >> 5); scr[kk * 33 + (lane & 31)] = m.W[(size_t)(k0 + kk) * m.N + n0 + (lane & 31)]; }
    LDS_WAIT(); asm volatile("" ::: "memory");
    const int c = lane & 7; const int drow0 = perm_row(m.type, n0);
#pragma unroll
    for (int j = 0; j < 4; ++j) { const int n = (lane >> 3) + 8 * j; const LAS float* s = scr + (8 * c) * 33 + n;
        u32x4 o; o.x = pk2(s[0 * 33], s[1 * 33]); o.y = pk2(s[2 * 33], s[3 * 33]); o.z = pk2(s[4 * 33], s[5 * 33]); o.w = pk2(s[6 * 33], s[7 * 33]);
        *(u32x4*)(m.WT + (size_t)(drow0 + n) * m.ldk + k0 + 8 * c) = o; }
    LDS_WAIT(); asm volatile("" ::: "memory");
}

__device__ __forceinline__ void pro_a(AP a, LAS unsigned char* lds, int tid, int wid, int lane) {
    const int G = GRD, bid = BID;
    if (bid < 288) {
        float* MOD = (float*)(a->ws + WS_MOD);
        LAS float* sl = (LAS float*)lds;
        LAS float* red = (LAS float*)(lds + 49152);
        for (int i = tid; i < NCI * D; i += 512) { const int ci = i >> 10, k = i & 1023; const float v = ci == 0 ? a->in[5][k] : a->in[4][(ci - 1) * D + k]; sl[k * 12 + ci] = v / (1.f + __expf(-v)); }
        __syncthreads();
        for (int it = bid; it < 288; it += G) {
            const int l = it / 72, n0 = (it % 72) * 128; const int kk = lane >> 5, c4 = lane & 31;
            const float* wp = a->in[6] + (size_t)l * D * NMODC + (size_t)(128 * wid + kk) * NMODC + n0 + 4 * c4;
            float acc[9][4];
#pragma unroll
            for (int ci = 0; ci < 9; ++ci)
#pragma unroll
                for (int e = 0; e < 4; ++e) acc[ci][e] = 0.f;
#pragma unroll 4
            for (int i = 0; i < 64; ++i) { const f32x4 w = *(const f32x4*)(wp + (size_t)(2 * i) * NMODC); const int k = 128 * wid + 2 * i + kk;
                const f32x4 s0 = *(const LAS f32x4*)(sl + k * 12), s1 = *(const LAS f32x4*)(sl + k * 12 + 4), s2 = *(const LAS f32x4*)(sl + k * 12 + 8);
#pragma unroll
                for (int e = 0; e < 4; ++e) { acc[0][e] += s0[0] * w[e]; acc[1][e] += s0[1] * w[e]; acc[2][e] += s0[2] * w[e]; acc[3][e] += s0[3] * w[e];
                    acc[4][e] += s1[0] * w[e]; acc[5][e] += s1[1] * w[e]; acc[6][e] += s1[2] * w[e]; acc[7][e] += s1[3] * w[e]; acc[8][e] += s2[0] * w[e]; } }
#pragma unroll
            for (int ci = 0; ci < 9; ++ci)
#pragma unroll
                for (int e = 0; e < 4; ++e) { acc[ci][e] += __shfl_xor(acc[ci][e], 32); if (kk == 0) red[(wid * 128 + 4 * c4 + e) * 9 + ci] = acc[ci][e]; }
            __syncthreads();
            for (int o = tid; o < 128 * 9; o += 512) { const int col = o / 9, ci = o % 9; float s = 0.f;
#pragma unroll
                for (int w = 0; w < 8; ++w) s += red[(w * 128 + col) * 9 + ci];
                MOD[((size_t)l * NCI + ci) * NMODC + n0 + col] = s + a->in[7][l * NMODC + n0 + col]; }
            __syncthreads();
        }
    }
    __syncthreads();
    { LAS float* scr = (LAS float*)(lds + wid * 16384); const int gw = bid * 8 + wid, NGW = G * 8; int base = 0;
      for (int id = 0; id < 26; ++id) { const MatDesc m = mat_desc(a, id); const int nit = (m.K / 64) * (m.N / 32);
          int first = (gw - base) % NGW; if (first < 0) first += NGW;
          for (int it = first; it < nit; it += NGW) transpose_item(m, scr, it, lane);
          base = (base + nit) % NGW; } }
    const int gt = bid * 512 + tid, NGT = G * 512;
    { bf16_t* wp = (bf16_t*)(a->ws + WS_WSQ) + (size_t)2 * D * D;
      for (int i = gt; i < D * 128; i += NGT) { const int row = i >> 7, ch = i & 127; if ((ch >> 5) != (row >> 8)) *(u32x4*)(wp + (size_t)row * D + ch * 8) = (u32x4){0u, 0u, 0u, 0u}; } }
    { float* st0 = (float*)(a->ws + WS_ST); for (int r = gt; r < T; r += NGT) st0[2 * r + 1] = (float)D * (1.f - LN_EPS);
      if (gt < D) { ((float*)(a->ws + WS_ONES))[gt] = 1.f; ((float*)(a->ws + WS_ZEROS))[gt] = 0.f; } }
    { for (int i = gt; i < 2 * 262144; i += NGT) { const int which = i >= 262144, j = i - which * 262144; const f32x4 v = *(const f32x4*)(a->in[2 + which] + (size_t)j * 4);
          u32x2_t o; o.x = pk2(v[0], v[1]); o.y = pk2(v[2], v[3]); *(u32x2_t*)((bf16_t*)(a->ws + (which ? WS_CV : WS_CK)) + (size_t)j * 4) = o; } }
}

__device__ __forceinline__ void pro_b(AP a, int tid, int wid, int lane) {
    const int G = GRD, bid = BID; const int gt = bid * 512 + tid, NGT = G * 512;
    const float* MOD = (const float*)(a->ws + WS_MOD); float* CS = (float*)(a->ws + WS_CS); float* CV = (float*)(a->ws + WS_CVEC); bf16_t* AUXA = (bf16_t*)(a->ws + WS_AUXA);
    float* GTAB = (float*)(a->ws + WS_GTAB);
    for (int idx = gt; idx < NCI * D; idx += NGT) CS[12 * NCI * D + idx] = 0.f;
    for (int idx = gt; idx < 12 * NCI * D; idx += NGT) { const int s = idx / (NCI * D), ci = (idx >> 10) % NCI, k = idx & 1023; const int layer = s / 3, j = s % 3;
        const float* mp = MOD + ((size_t)layer * NCI + ci) * NMODC + 3 * j * D + k; const float shift = mp[0], scale = mp[D];
        const float g = s ? a->in[8][(s - 1) * D + k] : 1.f, b = s ? a->in[9][(s - 1) * D + k] : 0.f;
        const float cs = g * (1.f + scale), cv = b * (1.f + scale) + shift; CS[idx] = cs; CV[idx] = cv;
        GTAB[idx] = mp[2 * D] * (j == 1 ? 1.f : 0.5f) * (s == 4 ? a->in[16][k] : 1.f);
        if (s != 4) { const int c = C_CIDX[s]; AUXA[((size_t)c * 256 + 2 * ci) * D + k] = (bf16_t)f2bf(cs); AUXA[((size_t)c * 256 + 2 * ci + 1) * D + k] = (bf16_t)f2bf(cv); } }
    bf16_t* ZT = (bf16_t*)(a->ws + WS_ZT); float* Z = a->out;
    for (int row = bid * 8 + wid; row < T; row += G * 8) { const int ci = ci_of_pm(row >> 8);
        const float* xr = row < TP ? a->in[0] + (size_t)row * D : a->in[1] + (size_t)(row - TP) * D; const float* sc = MOD + (size_t)ci * NMODC + D;
#pragma unroll
        for (int j = 0; j < 4; ++j) { const int col = 4 * (lane + 64 * j); const f32x4 x = *(const f32x4*)(xr + col), s = *(const f32x4*)(sc + col); *(f32x4*)(Z + (size_t)row * D + col) = x;
            u32x2_t o; o.x = pk2(x[0] * (1.f + s[0]), x[1] * (1.f + s[1])); o.y = pk2(x[2] * (1.f + s[2]), x[3] * (1.f + s[3])); *(u32x2_t*)(ZT + (size_t)row * D + col) = o; } }
}

__device__ __forceinline__ void conv_pass(AP a, int j, int tid) {
    const int G = GRD, bid = BID;
    const bf16_t* U3 = (const bf16_t*)(a->ws + HID_U3); const bf16_t* BG = (const bf16_t*)(a->ws + HID_BG); bf16_t* A2 = (bf16_t*)(a->ws + HID_A2); const float* ck = a->in[13] + (size_t)j * 3 * D;
    const int NGT = G * 512;
    for (int idx = bid * 512 + tid; idx < T * 128; idx += NGT) { const int r = idx >> 7, col = (idx & 127) * 8;
        const int t = r < TP ? (r & 255) : ((r - TP) & 2047); const int L = r < TP ? 256 : 2048;
        const u32x4 z4 = (u32x4){0u, 0u, 0u, 0u};
        const u32x4 u0 = t == 0 ? z4 : *(const u32x4*)(U3 + (size_t)(r - 1) * D + col), u1 = *(const u32x4*)(U3 + (size_t)r * D + col), u2 = t == L - 1 ? z4 : *(const u32x4*)(U3 + (size_t)(r + 1) * D + col);
        const u32x4 bg = *(const u32x4*)(BG + (size_t)r * D + col);
        f32x4 k0[2], k1[2], k2[2];
#pragma unroll
        for (int h = 0; h < 2; ++h) { k0[h] = *(const f32x4*)(ck + col + 4 * h); k1[h] = *(const f32x4*)(ck + D + col + 4 * h); k2[h] = *(const f32x4*)(ck + 2 * D + col + 4 * h); }
        float o[8];
#pragma unroll
        for (int w = 0; w < 4; ++w) { const int h = w >> 1, e = (w & 1) * 2;
            o[2 * w] = bflo(bg[w]) * (bflo(u0[w]) * k0[h][e] + bflo(u1[w]) * k1[h][e] + bflo(u2[w]) * k2[h][e]);
            o[2 * w + 1] = bfhi(bg[w]) * (bfhi(u0[w]) * k0[h][e + 1] + bfhi(u1[w]) * k1[h][e + 1] + bfhi(u2[w]) * k2[h][e + 1]); }
        u32x4 ov; ov.x = pk2(o[0], o[1]); ov.y = pk2(o[2], o[3]); ov.z = pk2(o[4], o[5]); ov.w = pk2(o[6], o[7]);
        *(u32x4*)(A2 + (size_t)r * D + col) = ov; }
}

__device__ __forceinline__ void pool_pre(AP a, LAS unsigned char* lds, int tid) {
    const int G = GRD, bid = BID;
    const float* Z = a->out; const float* stp = (const float*)(a->ws + WS_ST) + (size_t)4 * T * 2; const float* CS = (const float*)(a->ws + WS_CS) + (size_t)4 * NCI * D; const float* CV = (const float*)(a->ws + WS_CVEC) + (size_t)4 * NCI * D;
    bf16_t* PD = (bf16_t*)(a->ws + HID_PD); LAS float* hb = (LAS float*)lds;
    for (int it = bid; it < 320 * 4; it += G) { const int g = it & 3, r0 = (it >> 2) * 64; const int ci = ci_of_pm(r0 >> 8);
        const int seqlo = r0 < TP ? (r0 & ~255) : TP + ((r0 - TP) & ~2047), seqhi = seqlo + (r0 < TP ? 256 : 2048);
        { const int c4 = (tid & 63) * 4, rg = tid >> 6; const f32x4 cs = *(const f32x4*)(CS + ci * D + 256 * g + c4), cv = *(const f32x4*)(CV + ci * D + 256 * g + c4);
          for (int lr = rg; lr < 79; lr += 8) { const int rr = r0 - 8 + lr; f32x4 h = (f32x4){0.f, 0.f, 0.f, 0.f};
              if (rr >= seqlo && rr < seqhi) { float ra, rc; row_ac(stp, rr, ra, rc); const f32x4 z = *(const f32x4*)(Z + (size_t)rr * D + 256 * g + c4); h = (z * ra + rc) * cs + cv; }
              *(LAS f32x4*)(hb + lr * 256 + c4) = h; } }
        __syncthreads();
        { const int c2 = (tid & 127) * 2, q = tid >> 7; const int hw = 1 << g;
          for (int i = 0; i < 16; ++i) { const int lt = q * 16 + i, t = r0 + lt; const int lo = max(t - hw, seqlo), hi = min(t + hw, seqhi); float s0 = 0.f, s1 = 0.f;
              for (int rr = lo; rr < hi; ++rr) { const f32x2_t v = *(const LAS f32x2_t*)(hb + (rr - r0 + 8) * 256 + c2); s0 += v.x; s1 += v.y; }
              const float inv = 1.f / (float)(hi - lo); const f32x2_t me = *(const LAS f32x2_t*)(hb + (lt + 8) * 256 + c2);
              *(unsigned*)(PD + (size_t)t * D + 256 * g + c2) = pk2(s0 * inv - me.x, s1 * inv - me.y); } }
        __syncthreads(); }
}

__device__ __forceinline__ void final_ln(AP a, int wid, int lane) {
    const int G = GRD, bid = BID;
    float* Z = a->out; const float* stp = (const float*)(a->ws + WS_ST) + (size_t)12 * T * 2; const float* g = a->in[8] + 11 * D; const float* b = a->in[9] + 11 * D;
    f32x4 gv[4], bv[4];
#pragma unroll
    for (int j = 0; j < 4; ++j) { gv[j] = *(const f32x4*)(g + 4 * (lane + 64 * j)); bv[j] = *(const f32x4*)(b + 4 * (lane + 64 * j)); }
    for (int row = bid * 8 + wid; row < T; row += G * 8) { float ra, rc; row_ac(stp, row, ra, rc);
#pragma unroll
        for (int j = 0; j < 4; ++j) { float* p = Z + (size_t)row * D + 4 * (lane + 64 * j); const f32x4 z = *(const f32x4*)p; *(f32x4*)p = (z * ra + rc) * gv[j] + bv[j]; } }
}

constexpr int AT_KP = 144, AT_VP = 192, AT_STG = 64 * AT_KP + 64 * AT_VP;
__device__ __forceinline__ int crow(int r, int hi) { return (r & 3) + 8 * (r >> 2) + 4 * hi; }
__device__ __forceinline__ void attn_phase(AP a, LAS unsigned char* lds, int tid, int wid, int lane) {
    const int G = GRD, bid = BID;
    const bf16_t* Q = (const bf16_t*)(a->ws + HID_Q); const bf16_t* Kb = (const bf16_t*)(a->ws + HID_K); const bf16_t* Vb = (const bf16_t*)(a->ws + HID_V);
    const bf16_t* CK = (const bf16_t*)(a->ws + WS_CK); const bf16_t* CV = (const bf16_t*)(a->ws + WS_CV); bf16_t* O = (bf16_t*)(a->ws + HID_O); const float* sink = a->in[19];
    const int r32 = lane & 31, hi = lane >> 5; const int skey = tid >> 3, sch = tid & 7;
    for (int uidx = bid; uidx < 1280; uidx += G) {
        int kvh, qb, b, rowbase, nband, t0; bool latent;
        if (uidx < 1024) { latent = true; kvh = uidx & 3; qb = (uidx >> 2) & 31; b = uidx >> 7; rowbase = TP + b * 2048; t0 = max(0, qb - 2); nband = min(31, qb + 2) - t0 + 1; }
        else { const int p = uidx - 1024; latent = false; kvh = p & 3; qb = (p >> 2) & 3; b = p >> 4; rowbase = b * 256; t0 = 0; nband = 4; }
        const int ntiles = nband + (latent ? 8 : 0);
        const int head = kvh * 4 + (wid & 3); const int qi = qb * 64 + 32 * (wid >> 2) + r32; const size_t qrow = (size_t)rowbase + qi;
        bf16x8_t qf[4];
#pragma unroll
        for (int d = 0; d < 4; ++d) qf[d] = *(const bf16x8_t*)(Q + qrow * D + head * 64 + 16 * d + 8 * hi);
        const float sink2 = sink[head] * LOG2E; float mrun = sink2, lrun = 0.f; f32x16_t o0 = {}, o1 = {};
#define AT_SRC(t, kp, vp) do { if ((t) < nband) { const size_t ro = ((size_t)rowbase + 64 * (t0 + (t)) + skey) * 256 + kvh * 64 + sch * 8; kp = Kb + ro; vp = Vb + ro; } \
        else { const size_t ro = ((size_t)b * 512 + 64 * ((t) - nband) + skey) * 256 + kvh * 64 + sch * 8; kp = CK + ro; vp = CV + ro; } } while (0)
        u32x4 kreg, vreg; { const bf16_t *kp, *vp; AT_SRC(0, kp, vp); kreg = *(const u32x4*)kp; vreg = *(const u32x4*)vp; }
        *(LAS u32x4*)(lds + skey * AT_KP + sch * 16) = kreg; *(LAS u32x4*)(lds + 64 * AT_KP + skey * AT_VP + sch * 16) = vreg;
        __syncthreads();
        for (int t = 0; t < ntiles; ++t) {
            if (t + 1 < ntiles) { const bf16_t *kp, *vp; AT_SRC(t + 1, kp, vp); kreg = *(const u32x4*)kp; vreg = *(const u32x4*)vp; }
            LAS unsigned char* Ks = lds + (t & 1) * AT_STG; LAS unsigned char* Vs = Ks + 64 * AT_KP;
            f32x16_t s0 = {}, s1 = {};
#pragma unroll
            for (int d = 0; d < 4; ++d) { const bf16x8_t k0 = *(const LAS bf16x8_t*)(Ks + r32 * AT_KP + (16 * d + 8 * hi) * 2), k1 = *(const LAS bf16x8_t*)(Ks + (32 + r32) * AT_KP + (16 * d + 8 * hi) * 2);
                s0 = __builtin_amdgcn_mfma_f32_32x32x16_bf16(k0, qf[d], s0, 0, 0, 0); s1 = __builtin_amdgcn_mfma_f32_32x32x16_bf16(k1, qf[d], s1, 0, 0, 0); }
            if (latent && t < nband) { const int kt = t0 + t; if (kt == qb - 2 || kt == qb + 2) { const int kb0 = 64 * kt;
#pragma unroll
                for (int r = 0; r < 16; ++r) { const int k0p = kb0 + crow(r, hi); int d0 = qi - k0p; d0 = d0 < 0 ? -d0 : d0; int d1 = qi - (k0p + 32); d1 = d1 < 0 ? -d1 : d1;
                    if (d0 > 128) s0[r] = -1e30f; if (d1 > 128) s1[r] = -1e30f; } } }
            float mx = fmaxf(s0[0], s1[0]);
#pragma unroll
            for (int r = 1; r < 16; ++r) mx = fmaxf(mx, fmaxf(s0[r], s1[r]));
            mx = fmaxf(mx, __shfl_xor(mx, 32));
            const float mnew = fmaxf(mrun, mx); const float f = __builtin_amdgcn_exp2f(mrun - mnew); mrun = mnew; lrun *= f;
#pragma unroll
            for (int r = 0; r < 16; ++r) { o0[r] *= f; o1[r] *= f; }
            float ps = 0.f;
#pragma unroll
            for (int r = 0; r < 16; ++r) { s0[r] = __builtin_amdgcn_exp2f(s0[r] - mnew); s1[r] = __builtin_amdgcn_exp2f(s1[r] - mnew); ps += s0[r] + s1[r]; }
            lrun += ps;
            bf16x8_t pf[2][2];
#pragma unroll
            for (int s2 = 0; s2 < 2; ++s2) { u32x4 w0, w1;
                w0.x = pg8::cvt_pk_bf16(s0[8 * s2 + 0], s0[8 * s2 + 1]); w0.y = pg8::cvt_pk_bf16(s0[8 * s2 + 2], s0[8 * s2 + 3]); w0.z = pg8::cvt_pk_bf16(s0[8 * s2 + 4], s0[8 * s2 + 5]); w0.w = pg8::cvt_pk_bf16(s0[8 * s2 + 6], s0[8 * s2 + 7]);
                w1.x = pg8::cvt_pk_bf16(s1[8 * s2 + 0], s1[8 * s2 + 1]); w1.y = pg8::cvt_pk_bf16(s1[8 * s2 + 2], s1[8 * s2 + 3]); w1.z = pg8::cvt_pk_bf16(s1[8 * s2 + 4], s1[8 * s2 + 5]); w1.w = pg8::cvt_pk_bf16(s1[8 * s2 + 6], s1[8 * s2 + 7]);
                pf[0][s2] = __builtin_bit_cast(bf16x8_t, w0); pf[1][s2] = __builtin_bit_cast(bf16x8_t, w1); }
            { const int gi = lane & 15, gq = gi >> 2, gp = gi & 3, gg = (lane >> 4) & 1;
              LAS unsigned char* vb = Vs + (4 * hi + gq) * AT_VP + (16 * gg + 4 * gp) * 2;
#pragma unroll
              for (int ks = 0; ks < 2; ++ks)
#pragma unroll
                for (int s2 = 0; s2 < 2; ++s2) {
#pragma unroll
                    for (int dt = 0; dt < 2; ++dt) { LAS unsigned char* p = vb + (32 * ks + 16 * s2) * AT_VP + dt * 64;
                        const s16x4_t lo = __builtin_bit_cast(s16x4_t, __builtin_amdgcn_ds_read_tr16_b64_v4i16((LAS s16x4_t*)p));
                        const s16x4_t hh = __builtin_bit_cast(s16x4_t, __builtin_amdgcn_ds_read_tr16_b64_v4i16((LAS s16x4_t*)(p + 8 * AT_VP)));
                        const bf16x8_t vf = (bf16x8_t){lo[0], lo[1], lo[2], lo[3], hh[0], hh[1], hh[2], hh[3]};
                        if (dt == 0) o0 = __builtin_amdgcn_mfma_f32_32x32x16_bf16(vf, pf[ks][s2], o0, 0, 0, 0); else o1 = __builtin_amdgcn_mfma_f32_32x32x16_bf16(vf, pf[ks][s2], o1, 0, 0, 0); } } }
            if (t + 1 < ntiles) { LAS unsigned char* Kn = lds + ((t + 1) & 1) * AT_STG; *(LAS u32x4*)(Kn + skey * AT_KP + sch * 16) = kreg; *(LAS u32x4*)(Kn + 64 * AT_KP + skey * AT_VP + sch * 16) = vreg; }
            __syncthreads();
        }
#undef AT_SRC
        const float ltot = lrun + __shfl_xor(lrun, 32) + __builtin_amdgcn_exp2f(sink2 - mrun); const float inv = 1.f / ltot;
        bf16_t* op = O + qrow * D + head * 64 + 4 * hi;
#pragma unroll
        for (int rg = 0; rg < 4; ++rg) { u32x2_t w0, w1;
            w0.x = pk2(o0[4 * rg] * inv, o0[4 * rg + 1] * inv); w0.y = pk2(o0[4 * rg + 2] * inv, o0[4 * rg + 3] * inv);
            w1.x = pk2(o1[4 * rg] * inv, o1[4 * rg + 1] * inv); w1.y = pk2(o1[4 * rg + 2] * inv, o1[4 * rg + 3] * inv);
            *(u32x2_t*)(op + 8 * rg) = w0; *(u32x2_t*)(op + 32 + 8 * rg) = w1; }
    }
}
typedef unsigned gu32_unused;
#define XB_TMO      128
#define XB_XCNT(j)  (256  + 64 * (j))
#define XB_XSUB(j)  (1280 + 64 * (j))
#define XB_XGEN(j)  (2304 + 64 * (j))
#define XB_TOP      3328
#define XB_TOPGEN   3392
#define XCD_BAR_WORDS 3456
#define XB_SPIN_CAP (1u << 18)

__device__ __forceinline__ unsigned xb_ld(unsigned* p)              { return __hip_atomic_load(p, __ATOMIC_RELAXED, __HIP_MEMORY_SCOPE_AGENT); }
__device__ __forceinline__ unsigned xb_add(unsigned* p, unsigned v) { return __hip_atomic_fetch_add(p, v, __ATOMIC_RELAXED, __HIP_MEMORY_SCOPE_AGENT); }
__device__ __forceinline__ unsigned xb_xcc_id() { return (unsigned)__builtin_amdgcn_s_getreg((3 << 11) | 20) & 0xFu; }
#define XB_SPIN(cond, bar) do { unsigned _sp = 0; while (cond) { __builtin_amdgcn_s_sleep(1); \
    if ((++_sp & 255u) == 0u) { if (xb_ld(&(bar)[XB_TMO])) break; if (_sp > XB_SPIN_CAP) { atomicAdd(&(bar)[XB_TMO], 1u); break; } } } } while (0)

struct XcdBarrier {
    unsigned* bar; unsigned x;
    volatile LAS unsigned* st;
};

__device__ __forceinline__ XcdBarrier xcd_barrier_post(unsigned* bar, volatile LAS unsigned* st) {
    XcdBarrier b; b.bar = bar; b.x = xb_xcc_id(); b.st = st;
    if (threadIdx.x == 0) (void)xb_add(&bar[XB_XCNT(b.x)], 1u);
    return b;
}
__device__ __forceinline__ void xcd_barrier_complete(unsigned* bar, unsigned x, unsigned& nloc, unsigned& nx) {
    const unsigned G = gridDim.x * gridDim.y * gridDim.z;
    unsigned sum, cnt, mine, sp = 0u;
    for (;;) {
        sum = 0u; cnt = 0u; mine = 0u;
#pragma unroll
        for (unsigned j = 0; j < 16; ++j) { const unsigned c = xb_ld(&bar[XB_XCNT(j)]); sum += c; cnt += (c > 0u) ? 1u : 0u; mine = (j == x) ? c : mine; }
        if (sum == G) break;
        __builtin_amdgcn_s_sleep(1);
        if ((++sp & 255u) == 0u) { if (xb_ld(&bar[XB_TMO])) break; if (sp > XB_SPIN_CAP) { atomicAdd(&bar[XB_TMO], 1u); break; } }
    }
    nloc = mine > 0u ? mine : 1u; nx = cnt > 0u ? cnt : 1u;
}

__device__ __forceinline__ void xcd_barrier(const XcdBarrier& b) {
    asm volatile("s_waitcnt vmcnt(0)" ::: "memory");
    __syncthreads();
    if (threadIdx.x == 0) {
        unsigned* bar = b.bar;
        __builtin_amdgcn_s_waitcnt(0);
        unsigned nloc = b.st[0], nx = b.st[1];
        if (nloc == 0u) { xcd_barrier_complete(bar, b.x, nloc, nx); b.st[0] = nloc; b.st[1] = nx; }
        const unsigned old = xb_add(&bar[XB_XSUB(b.x)], 1u);
        const unsigned gen = old / nloc;
        if (old + 1u == (gen + 1u) * nloc) {
            __builtin_amdgcn_fence(__ATOMIC_RELEASE, "agent");
            asm volatile("s_waitcnt vmcnt(0)" ::: "memory");
            const unsigned og = xb_add(&bar[XB_TOP], 1u);
            const unsigned tg = og / nx;
            if (og + 1u == (tg + 1u) * nx) xb_add(&bar[XB_TOPGEN], 1u);
            else XB_SPIN(xb_ld(&bar[XB_TOPGEN]) == tg, bar);
            __builtin_amdgcn_fence(__ATOMIC_ACQUIRE, "agent");
            xb_add(&bar[XB_XGEN(b.x)], 1u);
            asm volatile("s_waitcnt vmcnt(0)" ::: "memory");
        } else {
            XB_SPIN(xb_ld(&bar[XB_XGEN(b.x)]) == gen, bar);
            __builtin_amdgcn_fence(__ATOMIC_ACQUIRE, "agent");
            asm volatile("s_waitcnt vmcnt(0)" ::: "memory");
        }
    }
    __syncthreads();
}

constexpr int CW_BAR = 4096;
constexpr int MISC_OFF = 131072 + 320;

__global__ void __launch_bounds__(512, 2) hybrid_fwd(Args a_unused) {
    extern __shared__ __attribute__((aligned(16))) unsigned char lds_raw[];
    LAS unsigned char* lds = (LAS unsigned char*)lds_raw;
    AP a0 = (AP)__builtin_amdgcn_kernarg_segment_ptr();
    const int step_lo = a0->lo, step_hi = a0->hi;
    volatile LAS unsigned* MISC = (volatile LAS unsigned*)(lds + MISC_OFF);
    if (threadIdx.x < 32) MISC[threadIdx.x] = 0u;
    __syncthreads();
#if MK_SINGLE && MK_XCDBAR
    XcdBarrier bar = xcd_barrier_post((unsigned*)(a0->ws + WS_CTL) + CW_BAR, MISC + 8);
#endif
    for (int step = step_lo; step < step_hi; ++step) {
#if MK_SINGLE
        if (step > step_lo) {
#if MK_XCDBAR
            if (step == step_lo + 1) cg::this_grid().sync(); else xcd_barrier(bar);
#else
            cg::this_grid().sync();
#endif
        }
#endif
        AP a = a0; asm volatile("" : "+s"(a));
        unsigned char* ws = a->ws;
        bf16_t* WSTK = (bf16_t*)(ws + WS_WSTK); bf16_t* WDN = (bf16_t*)(ws + WS_WDN); bf16_t* WSQ = (bf16_t*)(ws + WS_WSQ); bf16_t* ZT = (bf16_t*)(ws + WS_ZT); bf16_t* HID = (bf16_t*)(ws + WS_HID);
        const int G = GRD, bid = BID;
        int tid_o = threadIdx.x; asm volatile("" : "+v"(tid_o));
        const int tid = tid_o, lane = tid & 63, wid = __builtin_amdgcn_readfirstlane(tid >> 6);
        const int ty = C_STEP_T[step], s = C_STEP_S[step];
#ifndef DBG_MASK
#define DBG_MASK 0xffff
#endif
#define EN(t) ((DBG_MASK >> (t)) & 1)
        const int layer = s / 3, j = s % 3;
        if (EN(ST_PROA) && ty == ST_PROA) { pro_a(a, lds, tid, wid, lane); __syncthreads(); }
        else if (EN(ST_PROB) && ty == ST_PROB) { pro_b(a, tid, wid, lane); }
        else if (EN(ST_AUX) && ty == ST_AUX) {
            pg8::Gemm g{(const bf16_t*)(ws + WS_AUXA), WSTK, 11 * 256, UVLD, D}; AuxSched S{G, bid}; EpiAux E{a};
            pg8::gemm_phase<EpiAux, AuxSched, true, true>(lds, g, S, E);
        }
        else if (EN(ST_GU) && ty == ST_GU) {
            pg8::Gemm g{ZT, WSTK + (size_t)C_SOFF[s] * D, T, 5632, D}; pg8::StaticOrder S; S.init(T, 5632, G, bid);
            EpiSwiGLU E{a, s};
            pg8::gemm_phase<EpiSwiGLU, pg8::StaticOrder, true, true>(lds, g, S, E);
        }
        else if (EN(ST_DN) && (ty == ST_DN || ty == ST_COUT || ty == ST_PGEMM || ty == ST_WO)) {
            pg8::Gemm g;
            if (ty == ST_DN) { const int f = 2 * layer + (j == 2 ? 1 : 0); g = pg8::Gemm{HID, WDN + (size_t)f * D * DFF, T, D, DFF}; }
            else if (ty == ST_COUT) g = pg8::Gemm{(const bf16_t*)(ws + HID_A2), WSQ + (size_t)(layer == 3 ? 1 : 0) * D * D, T, D, D};
            else if (ty == ST_PGEMM) g = pg8::Gemm{(const bf16_t*)(ws + HID_PD), WSQ + (size_t)2 * D * D, T, D, D};
            else g = pg8::Gemm{(const bf16_t*)(ws + HID_O), WSQ + (size_t)3 * D * D, T, D, D};
            pg8::StaticOrder S; S.init(T, D, G, bid);
            EpiResid E{a, s};
            pg8::gemm_phase<EpiResid, pg8::StaticOrder, true, true>(lds, g, S, E);
        }
        else if (EN(ST_CIN) && ty == ST_CIN) {
            pg8::Gemm g{ZT, WSTK + (size_t)C_SOFF[s] * D, T, 3072, D}; pg8::StaticOrder S; S.init(T, 3072, G, bid);
            EpiConvIn E{a, s};
            pg8::gemm_phase<EpiConvIn, pg8::StaticOrder, true, true>(lds, g, S, E);
        }
        else if (EN(ST_CONV) && ty == ST_CONV) { conv_pass(a, layer == 3 ? 1 : 0, tid); }
        else if (EN(ST_PPRE) && ty == ST_PPRE) { pool_pre(a, lds, tid); }
        else if (EN(ST_QKV) && ty == ST_QKV) {
            pg8::Gemm g{ZT, WSTK + (size_t)C_SOFF[s] * D, T, 1536, D}; pg8::StaticOrder S; S.init(T, 1536, G, bid);
            EpiQKV E{a, s};
            pg8::gemm_phase<EpiQKV, pg8::StaticOrder, true, true>(lds, g, S, E);
        }
        else if (EN(ST_ATTN) && ty == ST_ATTN) { attn_phase(a, lds, tid, wid, lane); }
        else if (EN(ST_FINAL) && ty == ST_FINAL) { final_ln(a, wid, lane); }
    }
}

extern "C" void kernel_launch(void* const* d_in, const int* in_sizes, int n_in, void* d_out, int out_size, void* d_ws, size_t ws_size, hipStream_t stream) {
    static int grid = 0;
    if (grid == 0) {
        if (n_in != 20 || ws_size < WS_END) { fprintf(stderr, "kernel_launch: unexpected n_in %d / ws %zu\n", n_in, ws_size); grid = -1; return; }
        int dev = 0, cus = 0, per_cu = 0;
        (void)hipGetDevice(&dev); (void)hipDeviceGetAttribute(&cus, hipDeviceAttributeMultiprocessorCount, dev);
        if (hipFuncSetAttribute((const void*)hybrid_fwd, hipFuncAttributeMaxDynamicSharedMemorySize, LDS_BYTES) != hipSuccess) { fprintf(stderr, "kernel_launch: hipFuncSetAttribute failed\n"); grid = -1; return; }
        if (hipOccupancyMaxActiveBlocksPerMultiprocessor(&per_cu, (const void*)hybrid_fwd, 512, LDS_BYTES) != hipSuccess || per_cu < 1) { fprintf(stderr, "kernel_launch: occupancy query says %d\n", per_cu); per_cu = 1; }
        (void)hipGetLastError();
        grid = cus * 1;
        fprintf(stderr, "kernel_launch: cus %d per_cu %d grid %d\n", cus, per_cu, grid);
    }
    if (grid < 0) return;
    (void)hipMemsetAsync((char*)d_ws + WS_CTL, 0, CTL_BYTES, stream);
    Args a{};
    for (int i = 0; i < 20; ++i) a.in[i] = (const float*)d_in[i];
    a.out = (float*)d_out; a.ws = (unsigned char*)d_ws;
#if MK_SINGLE
    a.lo = 0; a.hi = NSTEPS;
    void* args[] = {&a};
    hipError_t e = hipLaunchCooperativeKernel((const void*)hybrid_fwd, dim3(grid), dim3(512), args, LDS_BYTES, stream);
    if (e != hipSuccess) fprintf(stderr, "kernel_launch: cooperative launch failed: %s (grid %d)\n", hipGetErrorString(e), grid);
#else
    for (int st = 0; st < NSTEPS; ++st) { a.lo = st; a.hi = st + 1; hipLaunchKernelGGL(hybrid_fwd, dim3(grid), dim3(512), LDS_BYTES, stream, a); }
#endif
}
```
